# Optimizing an MI355X kernel written in HIP

```python
import jax, jax.numpy as jnp
from jax import lax
import numpy as np

D_MODEL = 1024
BATCH = 4
SEQ = 8192
DEPTH = 1

N_META = 16
BLOCK = 128
PAD = BLOCK - N_META
HEAD_DIM = 64
SB_HEADS = 8
SB_WIDTH = SB_HEADS * HEAD_DIM
SWA_Q_HEADS = 16
SWA_KV_HEADS = 2
SWA_GROUP = SWA_Q_HEADS // SWA_KV_HEADS
SWA_WIDTH = SWA_Q_HEADS * HEAD_DIM
SWA_KV_WIDTH = SWA_KV_HEADS * HEAD_DIM
WINDOW = 128
ROPE_THETA = 10000.0
RMS_EPS = 1e-6
SPLITS = (SB_WIDTH, SB_WIDTH, SB_WIDTH, SWA_WIDTH, SWA_KV_WIDTH, SWA_KV_WIDTH, SB_WIDTH, SWA_WIDTH, D_MODEL, D_MODEL)
IN_COLS = sum(SPLITS)

kernel_name = "hybrid_stickbreak_swa_sink_gated"


def rms_norm(x, g):
    xf = x.astype(jnp.float32)
    y = xf * lax.rsqrt(jnp.mean(xf * xf, axis=-1, keepdims=True) + RMS_EPS)
    return (y * g.astype(jnp.float32)).astype(x.dtype)


def rope(x, pos):
    half = HEAD_DIM // 2
    inv = ROPE_THETA ** (-jnp.arange(half, dtype=jnp.float32) / half)
    ang = pos.astype(jnp.float32)[:, None] * inv[None, :]
    cos = jnp.cos(ang)[None, :, None, :]
    sin = jnp.sin(ang)[None, :, None, :]
    x1 = x[..., :half].astype(jnp.float32)
    x2 = x[..., half:].astype(jnp.float32)
    out = jnp.concatenate([x1 * cos - x2 * sin, x2 * cos + x1 * sin], axis=-1)
    return out.astype(x.dtype)


def stick_breaking_attention(q, k, v, valid):
    B, L, H, d = q.shape
    scale = d ** -0.5
    outs = []
    for blk in range(L // BLOCK):
        q0 = blk * BLOCK
        end = q0 + BLOCK
        z = jnp.einsum('bqhd,bkhd->bhqk', q[:, q0:end], k[:, :end],
                       preferred_element_type=jnp.float32) * scale
        t = q0 + jnp.arange(BLOCK)
        s = jnp.arange(end)
        mask = (s[None, :] < t[:, None]) & valid[None, :end]
        log_beta = jax.nn.log_sigmoid(z)
        log_1m = jnp.where(mask, log_beta - z, 0.0)
        rev = lax.cumsum(log_1m, axis=3, reverse=True)
        suffix = jnp.concatenate([rev[..., 1:], jnp.zeros_like(rev[..., :1])], axis=-1)
        w = jnp.where(mask, jnp.exp(log_beta + suffix), 0.0)
        outs.append(jnp.einsum('bhqk,bkhd->bqhd', w.astype(v.dtype), v[:, :end]))
    return jnp.concatenate(outs, axis=1)


def sliding_window_sink_attention(q, k, v, sinks, valid):
    B, L, Hq, d = q.shape
    nb = L // BLOCK
    scale = d ** -0.5
    qb = q.reshape(B, nb, BLOCK, SWA_KV_HEADS, SWA_GROUP, d)

    def band(t):
        tb = t.reshape(B, nb, BLOCK, SWA_KV_HEADS, d)
        prev = jnp.pad(tb[:, :-1], ((0, 0), (1, 0), (0, 0), (0, 0), (0, 0)))
        return jnp.concatenate([prev, tb], axis=2)

    kb, vb = band(k), band(v)
    vblk = valid.reshape(nb, BLOCK)
    kvalid = jnp.concatenate([jnp.pad(vblk[:-1], ((1, 0), (0, 0)), constant_values=False), vblk], axis=1)
    scores = jnp.einsum('bnqhgd,bnkhd->bnhgqk', qb, kb,
                        preferred_element_type=jnp.float32) * scale
    diff = (BLOCK + jnp.arange(BLOCK))[:, None] - jnp.arange(2 * BLOCK)[None, :]
    mask = ((diff >= 0) & (diff < WINDOW))[None] & kvalid[:, None, :]
    scores = jnp.where(mask[None, :, None, None], scores, -jnp.inf)
    sink = sinks.astype(jnp.float32).reshape(SWA_KV_HEADS, SWA_GROUP)[None, None, :, :, None, None]
    sink = jnp.broadcast_to(sink, scores.shape[:-1] + (1,))
    probs = jax.nn.softmax(jnp.concatenate([scores, sink], axis=-1), axis=-1)[..., :-1]
    o = jnp.einsum('bnhgqk,bnkhd->bnqhgd', probs.astype(v.dtype), vb)
    return o.reshape(B, L, Hq * d)


def setup_inputs(seed: int = 0) -> dict:
    key = jax.random.key(seed)
    ks = jax.random.split(key, 10)
    f32 = jnp.float32
    x = jax.random.normal(ks[0], (BATCH, SEQ, D_MODEL), f32)
    meta_tokens = jax.random.normal(ks[1], (N_META, D_MODEL), f32)
    norm_gain = 1.0 + 0.02 * jax.random.normal(ks[2], (DEPTH, D_MODEL), f32)
    w_in = jax.random.normal(ks[3], (DEPTH, D_MODEL, IN_COLS), f32) * D_MODEL ** -0.5
    w_branch_sb = jax.random.normal(ks[4], (DEPTH, SB_WIDTH, D_MODEL), f32) * SB_WIDTH ** -0.5
    w_branch_swa = jax.random.normal(ks[5], (DEPTH, SWA_WIDTH, D_MODEL), f32) * SWA_WIDTH ** -0.5
    w_out = jax.random.normal(ks[6], (DEPTH, D_MODEL, D_MODEL), f32) * D_MODEL ** -0.5
    attn_sinks = jax.random.normal(ks[7], (DEPTH, SWA_Q_HEADS), f32)
    final_norm_gain = 1.0 + 0.02 * jax.random.normal(ks[8], (D_MODEL,), f32)
    return {"x": x, "meta_tokens": meta_tokens, "norm_gain": norm_gain, "w_in": w_in,
            "w_branch_sb": w_branch_sb, "w_branch_swa": w_branch_swa, "w_out": w_out,
            "attn_sinks": attn_sinks, "final_norm_gain": final_norm_gain}


def reference(x, meta_tokens, norm_gain, w_in, w_branch_sb, w_branch_swa, w_out, attn_sinks, final_norm_gain):
    B = x.shape[0]
    meta = jnp.broadcast_to(meta_tokens[None].astype(x.dtype), (B, N_META, D_MODEL))
    pad = jnp.zeros((B, PAD, D_MODEL), x.dtype)
    h = jnp.concatenate([pad, meta, x], axis=1)
    L = h.shape[1]
    idx = jnp.arange(L)
    valid = idx >= PAD
    pos = idx - PAD
    offsets = [int(o) for o in np.cumsum(SPLITS)[:-1]]
    for l in range(DEPTH):
        xn = rms_norm(h, norm_gain[l])
        proj = xn @ w_in[l]
        sb_q, sb_k, sb_v, sw_q, sw_k, sw_v, sb_z, sw_z, g_sb, g_sw = jnp.split(proj, offsets, axis=-1)
        o_sb = stick_breaking_attention(sb_q.reshape(B, L, SB_HEADS, HEAD_DIM),
                                        sb_k.reshape(B, L, SB_HEADS, HEAD_DIM),
                                        sb_v.reshape(B, L, SB_HEADS, HEAD_DIM), valid).reshape(B, L, SB_WIDTH)
        q = rope(sw_q.reshape(B, L, SWA_Q_HEADS, HEAD_DIM), pos)
        k = rope(sw_k.reshape(B, L, SWA_KV_HEADS, HEAD_DIM), pos)
        o_sw = sliding_window_sink_attention(q, k, sw_v.reshape(B, L, SWA_KV_HEADS, HEAD_DIM),
                                             attn_sinks[l], valid)
        y_sb = (o_sb * jax.nn.silu(sb_z)) @ w_branch_sb[l]
        y_sw = (o_sw * jax.nn.silu(sw_z)) @ w_branch_swa[l]
        merged = jax.nn.sigmoid(g_sb) * y_sb + jax.nn.sigmoid(g_sw) * y_sw
        h = h + merged @ w_out[l]
    return rms_norm(h, final_norm_gain)[:, BLOCK:]
```

```cpp
#include <hip/hip_runtime.h>
#include <cstdio>
#include <cstdint>
#include <cmath>
namespace pg8 {
#define PG8_LAS __attribute__((address_space(3)))
typedef unsigned short bf16_t;
typedef short bf16x8 __attribute__((ext_vector_type(8)));
typedef float f32x4 __attribute__((ext_vector_type(4)));
typedef unsigned u32x4 __attribute__((ext_vector_type(4)));
constexpr int BM = 256, BK = 64, HALF = 128, HTB = HALF * BK * 2  , STAGE_BYTES = 8 * HTB, NXCD = 8, WGM = 8;

__host__ __device__ __forceinline__ int lds_byte(int r, int c) { const int st = (r >> 4) * 2 + (c >> 5), rr = r & 15, cc = c & 31, ob = rr * 64 + cc * 2; return st * 1024 + (ob ^ (((ob >> 9) & 1) << 5)); }
__host__ __device__ __forceinline__ void stage_rc(int b, int& R, int& C) { const int st = b / 1024, sb = b % 1024, swz = sb ^ (((sb >> 9) & 1) << 5); R = (st >> 1) * 16 + swz / 64; C = (st & 1) * 32 + (swz % 64) / 2; }
__host__ __device__ __forceinline__ int perm32(int rho) { const int n = rho >> 4, i = rho & 15; return 8 * (i >> 2) + 4 * n + (i & 3); }

struct Unit { int pm, pn; };
struct Gemm { const bf16_t* A; const bf16_t* Bt; int M, N, K; };

struct StaticOrder {
    int nM, nN, nwg, G, c;
    __host__ __device__ void init(int M, int N, int G_, int c_) { nM = M / BM; nN = N / BM; nwg = nM * nN; G = G_; c = c_; }
    __host__ __device__ bool next(int i, Unit& u) const {
        const long L = (long)i * G + c; if (L >= nwg) return false;
        int wgid = (int)L; { const int q = nwg / NXCD, r = nwg % NXCD, xcd = wgid % NXCD, off = wgid / NXCD; wgid = (xcd < r ? xcd * (q + 1) : r * (q + 1) + (xcd - r) * q) + off; }
        const int nig = WGM * nN, gid = wgid / nig, fm = gid * WGM, gsz = (nM - fm) < WGM ? (nM - fm) : WGM;
        u.pm = fm + ((wgid % nig) % gsz); u.pn = (wgid % nig) / gsz; return true;
    }
    __device__ __forceinline__ void a_ready(const Unit&) const {}
    __device__ __forceinline__ void done(const Unit&) const {}
};

__device__ __forceinline__ unsigned cvt_pk_bf16(float lo, float hi) { unsigned r; asm volatile("v_cvt_pk_bf16_f32 %0, %1, %2" : "=v"(r) : "v"(lo), "v"(hi)); return r; }
typedef float f32x2 __attribute__((ext_vector_type(2)));
__device__ __forceinline__ f32x2 gelu_pk(f32x2 v) {
    const f32x2 av = __builtin_elementwise_abs(v), d = av * 0.2316418882f + 1.0f;
    f32x2 t; t.x = __builtin_amdgcn_rcpf(d.x); t.y = __builtin_amdgcn_rcpf(d.y);
    f32x2 q = t * 0.5307027145f + (-0.7265760135f); q = q * t + 0.7107068705f; q = q * t + (-0.142248368f); q = q * t + 0.127414796f; q = q * t;
    const f32x2 s = (v * v) * (-0.72134752044f);
    f32x2 e; e.x = __builtin_amdgcn_exp2f(s.x); e.y = __builtin_amdgcn_exp2f(s.y);
    const f32x2 m = v * (q * e), r = v - m;
    f32x2 o; o.x = v.x < 0.f ? m.x : r.x; o.y = v.y < 0.f ? m.y : r.y; return o;
}

template <int ACT  > struct EpiBf16 {
    static constexpr bool PERM = true, AFTER_DRAIN = false; static_assert(ACT == 0 || ACT == 1, "EpiBf16: ACT is 0 (none) or 1 (gelu_pk)");
    bf16_t* O; int ldc; const float* bias; int split_cols; size_t split_stride; float scale0;
    __device__ __forceinline__ void operator()(const f32x4 (&acc)[2][2][4][2], const Unit& u, int wr, int wc, int fr, int fq) const {
        const int row0 = u.pm * BM + wr * 64 + fr; int colt = u.pn * BM; bf16_t* base = O;
        float sc = 1.f; if (split_cols) { const int t = colt / split_cols; base += (size_t)t * split_stride; colt -= t * split_cols; if (t == 0) sc = scale0; }
        const int col0 = colt + wc * 32 + 8 * fq, bcol0 = u.pn * BM + wc * 32 + 8 * fq;
        f32x4 bv[2][2];
#pragma unroll
        for (int bj = 0; bj < 2; ++bj)
#pragma unroll
            for (int n = 0; n < 2; ++n) bv[bj][n] = bias ? *(const f32x4*)(bias + bcol0 + bj * HALF + 4 * n) : (f32x4){0.f, 0.f, 0.f, 0.f};
#pragma unroll
        for (int ai = 0; ai < 2; ++ai)
#pragma unroll
            for (int m = 0; m < 4; ++m) { bf16_t* rowp = base + (size_t)(row0 + ai * HALF + m * 16) * ldc + col0;
#pragma unroll
                for (int bj = 0; bj < 2; ++bj) { f32x4 v0 = acc[ai][bj][m][0] + bv[bj][0], v1 = acc[ai][bj][m][1] + bv[bj][1];
                    if (ACT == 1) { f32x2 a = gelu_pk((f32x2){v0[0], v0[1]}), b = gelu_pk((f32x2){v0[2], v0[3]}), c = gelu_pk((f32x2){v1[0], v1[1]}), d = gelu_pk((f32x2){v1[2], v1[3]});
                        v0 = (f32x4){a.x, a.y, b.x, b.y}; v1 = (f32x4){c.x, c.y, d.x, d.y}; }
                    v0 = v0 * sc; v1 = v1 * sc; u32x4 w; w.x = cvt_pk_bf16(v0[0], v0[1]); w.y = cvt_pk_bf16(v0[2], v0[3]); w.z = cvt_pk_bf16(v1[0], v1[1]); w.w = cvt_pk_bf16(v1[2], v1[3]);
                    *(u32x4*)(rowp + bj * HALF) = w; } }
    }
};

struct PanelStats {
    unsigned* xbuf;
    unsigned* cnt;
    unsigned* tmo;
    int ntn; float eps;
    unsigned code;
    __device__ __forceinline__ bool run(const f32x4 (&v)[2][2][4][2], const Unit& u, int wr, int wc, int fr, int fq, PG8_LAS unsigned char* lds, int wid, int lane) const {
        typedef float f32x2v __attribute__((ext_vector_type(2)));
        PG8_LAS f32x2v* P = (PG8_LAS f32x2v*)lds;
        PG8_LAS f32x2v* S = (PG8_LAS f32x2v*)(lds + 8192);
        PG8_LAS unsigned* flag = (PG8_LAS unsigned*)(lds + 8192 + 2048);
#pragma unroll
        for (int ai = 0; ai < 2; ++ai)
#pragma unroll
            for (int m = 0; m < 4; ++m) {
                float s = 0.f;
#pragma unroll
                for (int bj = 0; bj < 2; ++bj)
#pragma unroll
                    for (int n = 0; n < 2; ++n) { const f32x4 x = v[ai][bj][m][n]; s += (x[0] + x[1]) + (x[2] + x[3]); }
                s += __shfl_xor(s, 16); s += __shfl_xor(s, 32);
                const float mw = s * (1.0f / 64.0f); float q = 0.f;
#pragma unroll
                for (int bj = 0; bj < 2; ++bj)
#pragma unroll
                    for (int n = 0; n < 2; ++n) { const f32x4 d = v[ai][bj][m][n] - mw; q += (d[0] * d[0] + d[1] * d[1]) + (d[2] * d[2] + d[3] * d[3]); }
                q += __shfl_xor(q, 16); q += __shfl_xor(q, 32);
                if (fq == 0) P[(ai * HALF + wr * 64 + m * 16 + fr) * 4 + wc] = (f32x2v){mw, q};
            }
        asm volatile("s_waitcnt lgkmcnt(0)" ::: "memory"); __builtin_amdgcn_s_barrier(); asm volatile("" ::: "memory");
#if defined(BROKEN_EXCHANGE_NO_WAIT)
#warning BROKEN CONTROL BUILD: the row-statistics exchange does not wait; results are wrong by design
        if (blockIdx.x >= 64) { const long long t0_ = clock64(); while (clock64() - t0_ < 60000) __builtin_amdgcn_s_sleep(8); }
#endif
        const int row = wid * 32 + (lane & 31);
        if (lane < 32) {
            const f32x2v a = P[row * 4 + 0], b = P[row * 4 + 1], c = P[row * 4 + 2], d = P[row * 4 + 3];
            const float mt = (a.x + b.x + c.x + d.x) * 0.25f;
            const float da = a.x - mt, db = b.x - mt, dc = c.x - mt, dd = d.x - mt;
            const float m2 = (a.y + b.y) + (c.y + d.y) + 64.0f * ((da * da + db * db) + (dc * dc + dd * dd));
            unsigned long long* slot = (unsigned long long*)xbuf + ((size_t)(u.pm * BM + row) * 4 + u.pn);
            __hip_atomic_store(slot, ((unsigned long long)__float_as_uint(m2) << 32) | __float_as_uint(mt), __ATOMIC_RELAXED, __HIP_MEMORY_SCOPE_AGENT);
        }
        asm volatile("s_waitcnt vmcnt(0)" ::: "memory");
        if (lane == 0) __hip_atomic_fetch_add(cnt + 64 * u.pm, 1u, __ATOMIC_RELAXED, __HIP_MEMORY_SCOPE_AGENT);
        if (wid == 0) {
            bool dead = false; const unsigned long long t0 = __builtin_amdgcn_s_memrealtime(); const unsigned want = 8u * (unsigned)ntn;
            for (;;) {
#if defined(BROKEN_EXCHANGE_NO_WAIT)
                break;
#endif
                if ((unsigned)__builtin_amdgcn_readfirstlane(__hip_atomic_load(cnt + 64 * u.pm, __ATOMIC_RELAXED, __HIP_MEMORY_SCOPE_AGENT)) >= want) break;
                if (__builtin_amdgcn_s_memrealtime() - t0 > 2000000ull) {
                    if (lane == 0) { unsigned expect = 0u; __hip_atomic_compare_exchange_strong(tmo + 1, &expect, code | (unsigned)(u.pm & 0xff), __ATOMIC_RELAXED, __ATOMIC_RELAXED, __HIP_MEMORY_SCOPE_AGENT);
                                     __hip_atomic_store(tmo, 1u, __ATOMIC_RELAXED, __HIP_MEMORY_SCOPE_AGENT); }
                    dead = true; break; }
                __builtin_amdgcn_s_sleep(2);
            }
            __builtin_amdgcn_fence(__ATOMIC_ACQUIRE, "agent");
            if (lane == 0) flag[0] = dead ? 1u : 0u;
        }
        asm volatile("s_waitcnt vmcnt(0) lgkmcnt(0)" ::: "memory"); __builtin_amdgcn_s_barrier(); asm volatile("" ::: "memory");
        const bool bad = flag[0] != 0u;
        if (lane < 32) {
            const unsigned long long* slot = (const unsigned long long*)xbuf + (size_t)(u.pm * BM + row) * 4; float mt[4], m2[4]; float ms = 0.f;
#pragma unroll
            for (int t = 0; t < 4; ++t) { if (t < ntn) { const unsigned long long w = __hip_atomic_load(slot + t, __ATOMIC_RELAXED, __HIP_MEMORY_SCOPE_AGENT); mt[t] = __uint_as_float((unsigned)w); m2[t] = __uint_as_float((unsigned)(w >> 32)); } else { mt[t] = 0.f; m2[t] = 0.f; } ms += mt[t]; }
            const float mean = ms / (float)ntn; float q = 0.f;
#pragma unroll
            for (int t = 0; t < 4; ++t) if (t < ntn) { const float dm = mt[t] - mean; q += m2[t] + 256.0f * dm * dm; }
            S[row] = (f32x2v){mean, 1.0f / sqrtf(q / (256.0f * (float)ntn) + eps)};
        }
        asm volatile("s_waitcnt lgkmcnt(0)" ::: "memory"); __builtin_amdgcn_s_barrier(); asm volatile("" ::: "memory");
        return bad;
    }
};
struct EpiLnRes {
    static constexpr bool PERM = false, AFTER_DRAIN = true;
    const float* base; float* out; int ldc; const float* bias; PanelStats st; unsigned poison;
    __device__ __forceinline__ void fused(f32x4 (&acc)[2][2][4][2], const Unit& u, int wr, int wc, int fr, int fq, PG8_LAS unsigned char* lds, int wid, int lane) const {
        typedef float f32x2v __attribute__((ext_vector_type(2)));
        const PG8_LAS f32x2v* S = (const PG8_LAS f32x2v*)(lds + 8192);
        const int col0 = u.pn * BM + wc * 32 + 4 * fq;
#pragma unroll
        for (int bj = 0; bj < 2; ++bj)
#pragma unroll
            for (int n = 0; n < 2; ++n) { const f32x4 bv = bias ? *(const f32x4*)(bias + col0 + bj * HALF + n * 16) : (f32x4){0.f, 0.f, 0.f, 0.f};
#pragma unroll
                for (int ai = 0; ai < 2; ++ai)
#pragma unroll
                    for (int m = 0; m < 4; ++m) acc[ai][bj][m][n] += bv; }
        f32x4 pre[4][2][2];
#pragma unroll
        for (int m = 0; m < 4; ++m) { const size_t off = (size_t)(u.pm * BM + wr * 64 + m * 16 + fr) * ldc + col0;
#pragma unroll
            for (int bj = 0; bj < 2; ++bj)
#pragma unroll
                for (int n = 0; n < 2; ++n) pre[m][bj][n] = *(const f32x4*)(base + off + bj * HALF + n * 16); }
        const bool bad = st.run(acc, u, wr, wc, fr, fq, lds, wid, lane) || poison != 0u;
        const float qnan = __builtin_nanf("");
#pragma unroll
        for (int ai = 0; ai < 2; ++ai)
#pragma unroll
            for (int m = 0; m < 4; ++m) { const int r = ai * HALF + wr * 64 + m * 16 + fr; const f32x2v sr = S[r]; const size_t off = (size_t)(u.pm * BM + r) * ldc + col0;
#pragma unroll
                for (int bj = 0; bj < 2; ++bj)
#pragma unroll
                    for (int n = 0; n < 2; ++n) { const f32x4 bs = ai == 0 ? pre[m][bj][n] : *(const f32x4*)(base + off + bj * HALF + n * 16); f32x4 o = bs + (acc[ai][bj][m][n] - sr.x) * sr.y;
                        if (bad) o = (f32x4){qnan, qnan, qnan, qnan}; *(f32x4*)(out + off + bj * HALF + n * 16) = o; }
                if (m & 1) asm volatile("" ::: "memory"); }
    }
};
struct EpiLnResLn {
    static constexpr bool PERM = false, AFTER_DRAIN = true;
    const float* base; float* out; bf16_t* xn; int ldc; const float* bias; PanelStats st1, st2; unsigned poison;
    __device__ __forceinline__ void fused(f32x4 (&acc)[2][2][4][2], const Unit& u, int wr, int wc, int fr, int fq, PG8_LAS unsigned char* lds, int wid, int lane) const {
        typedef float f32x2v __attribute__((ext_vector_type(2))); typedef unsigned u32x2v __attribute__((ext_vector_type(2)));
        const PG8_LAS f32x2v* S = (const PG8_LAS f32x2v*)(lds + 8192);
        const int col0 = u.pn * BM + wc * 32 + 4 * fq;
#pragma unroll
        for (int bj = 0; bj < 2; ++bj)
#pragma unroll
            for (int n = 0; n < 2; ++n) { const f32x4 bv = bias ? *(const f32x4*)(bias + col0 + bj * HALF + n * 16) : (f32x4){0.f, 0.f, 0.f, 0.f};
#pragma unroll
                for (int ai = 0; ai < 2; ++ai)
#pragma unroll
                    for (int m = 0; m < 4; ++m) acc[ai][bj][m][n] += bv; }
        bool bad = st1.run(acc, u, wr, wc, fr, fq, lds, wid, lane) || poison != 0u;
        const float qnan = __builtin_nanf("");
#pragma unroll
        for (int ai = 0; ai < 2; ++ai)
#pragma unroll
            for (int m = 0; m < 4; ++m) { const int r = ai * HALF + wr * 64 + m * 16 + fr; const f32x2v sr = S[r]; const size_t off = (size_t)(u.pm * BM + r) * ldc + col0;
#pragma unroll
                for (int bj = 0; bj < 2; ++bj)
#pragma unroll
                    for (int n = 0; n < 2; ++n) { const f32x4 bs = *(const f32x4*)(base + off + bj * HALF + n * 16); acc[ai][bj][m][n] = bs + (acc[ai][bj][m][n] - sr.x) * sr.y; }
                asm volatile("" : "+v"(acc[ai][0][m][0]), "+v"(acc[ai][0][m][1]), "+v"(acc[ai][1][m][0]), "+v"(acc[ai][1][m][1]));
                if (m & 1) asm volatile("" ::: "memory"); }
        const bool bad1 = bad;
        bad = st2.run(acc, u, wr, wc, fr, fq, lds, wid, lane) || bad;
#pragma unroll
        for (int ai = 0; ai < 2; ++ai)
#pragma unroll
            for (int m = 0; m < 4; ++m) { const int r = ai * HALF + wr * 64 + m * 16 + fr; const f32x2v sr = S[r]; const size_t off = (size_t)(u.pm * BM + r) * ldc + col0;
#pragma unroll
                for (int bj = 0; bj < 2; ++bj)
#pragma unroll
                    for (int n = 0; n < 2; ++n) { const f32x4 x1 = acc[ai][bj][m][n]; *(f32x4*)(out + off + bj * HALF + n * 16) = bad1 ? (f32x4){qnan, qnan, qnan, qnan} : x1;
                        const f32x4 o = (x1 - sr.x) * sr.y; u32x2v w; w.x = cvt_pk_bf16(o[0], o[1]); w.y = cvt_pk_bf16(o[2], o[3]);
                        if (bad) { w.x = 0x7fc07fc0u; w.y = 0x7fc07fc0u; } *(u32x2v*)(xn + off + bj * HALF + n * 16) = w; }
                asm volatile("" ::: "memory"); }
    }
};

template <class Epi, class Sched, bool ALIGN_EPI = false, bool SP2 = false>
__device__ __forceinline__ void gemm_phase(PG8_LAS unsigned char* lds, const Gemm g, const Sched& S, const Epi& E) {
    const int tid = threadIdx.x, wid = __builtin_amdgcn_readfirstlane(tid >> 6), lane = tid & 63, wr = wid >> 2, wc = wid & 3, fr = lane & 15, fq = lane >> 4;
    const int K = g.K, nt = K / BK;
    unsigned voffA[2], voffB[2];
#pragma unroll
    for (int i = 0; i < 2; ++i) { int R, C; stage_rc(tid * 16 + i * 8192, R, C); const int Rb = Epi::PERM ? ((R & ~31) + perm32(R & 31)) : R;
        voffA[i] = (unsigned)(R * K + C) * 2u; voffB[i] = (unsigned)(Rb * K + C) * 2u; }
    const size_t kstep = (size_t)(BK * 2);
    const size_t hstep = (size_t)HALF * K * 2;
    const size_t tstep = 2 * hstep;
    const unsigned ldsw = (unsigned)wid * 1024u;
    const int aoff = lds_byte(wr * 64 + fr, fq * 8), boff = lds_byte(wc * 32 + fr, fq * 8);
#define PG8_SA(b, h) (((b) * 2 + (h)) * HTB)
#define PG8_SB(b, h) ((4 + (b) * 2 + (h)) * HTB)
#define PG8_STAGE(bufoff, gbase, voff) do { _Pragma("unroll") for (int _i = 0; _i < 2; ++_i) \
        __builtin_amdgcn_global_load_lds((const unsigned*)((const char*)(gbase) + (voff)[_i]), (PG8_LAS unsigned*)(lds + (bufoff) + ldsw + _i * 8192), 16, 0, 0); } while (0)
#define PG8_LDA(dst, b, h) do { _Pragma("unroll") for (int m = 0; m < 4; ++m) _Pragma("unroll") for (int k = 0; k < 2; ++k) dst[m][k] = *(const PG8_LAS bf16x8*)(lds + PG8_SA(b, h) + aoff + m * 2048 + k * 1024); } while (0)
#define PG8_LDB(dst, b, h) do { _Pragma("unroll") for (int n = 0; n < 2; ++n) _Pragma("unroll") for (int k = 0; k < 2; ++k) dst[n][k] = *(const PG8_LAS bf16x8*)(lds + PG8_SB(b, h) + boff + n * 2048 + k * 1024); } while (0)
#define PG8_MMA(ai, bj, At, Bt) do { __builtin_amdgcn_s_setprio(1); _Pragma("unroll") for (int m = 0; m < 4; ++m) _Pragma("unroll") for (int n = 0; n < 2; ++n) _Pragma("unroll") for (int k = 0; k < 2; ++k) \
        acc[ai][bj][m][n] = __builtin_amdgcn_mfma_f32_16x16x32_bf16(Bt[n][k], At[m][k], acc[ai][bj][m][n], 0, 0, 0); __builtin_amdgcn_s_setprio(0); } while (0)
#define PG8_WAIT_V(n) asm volatile("s_waitcnt vmcnt(" #n ")" ::: "memory")
#define PG8_WAIT_L(n) asm volatile("s_waitcnt lgkmcnt(" #n ")" ::: "memory")
#define PG8_BAR __builtin_amdgcn_s_barrier()
#define PG8_SCHED __builtin_amdgcn_sched_barrier(0)
    Unit cur, nxt; int ui = 0;
    if (!S.next(0, cur)) return;
    f32x4 acc[2][2][4][2];
#pragma unroll
    for (int a = 0; a < 2; ++a)
#pragma unroll
        for (int b = 0; b < 2; ++b)
#pragma unroll
            for (int m = 0; m < 4; ++m)
#pragma unroll
                for (int n = 0; n < 2; ++n) acc[a][b][m][n] = (f32x4){0.f, 0.f, 0.f, 0.f};
    bf16x8 At[4][2], B0[2][2], B1[2][2];
    const char* cA = (const char*)g.A + (size_t)cur.pm * tstep; const char* cB = (const char*)g.Bt + (size_t)cur.pn * tstep;
    S.a_ready(cur);
    if constexpr (SP2) {
        PG8_STAGE(PG8_SB(0, 0), cB, voffB); PG8_STAGE(PG8_SB(0, 1), cB + hstep, voffB); PG8_STAGE(PG8_SA(0, 0), cA, voffA); PG8_STAGE(PG8_SA(0, 1), cA + hstep, voffA);
        if (wr == 1) PG8_BAR;
        PG8_WAIT_V(2); PG8_BAR;
        PG8_STAGE(PG8_SB(1, 0), cB + kstep, voffB); PG8_STAGE(PG8_SA(1, 0), cA + kstep, voffA); PG8_STAGE(PG8_SB(1, 1), cB + hstep + kstep, voffB);
        PG8_WAIT_V(6); PG8_BAR;
    } else {
        PG8_STAGE(PG8_SB(0, 0), cB, voffB); PG8_STAGE(PG8_SA(0, 0), cA, voffA); PG8_STAGE(PG8_SB(0, 1), cB + hstep, voffB); PG8_STAGE(PG8_SA(0, 1), cA + hstep, voffA);
        if (wr == 1) PG8_BAR;
        PG8_WAIT_V(4); PG8_BAR;
        PG8_STAGE(PG8_SB(1, 0), cB + kstep, voffB); PG8_STAGE(PG8_SA(1, 0), cA + kstep, voffA); PG8_STAGE(PG8_SB(1, 1), cB + hstep + kstep, voffB);
        PG8_WAIT_V(6); PG8_BAR;
    }
    for (;;) {
        const bool has_next = S.next(ui + 1, nxt);
        const char* nA = has_next ? (const char*)g.A + (size_t)nxt.pm * tstep : cA; const char* nB = has_next ? (const char*)g.Bt + (size_t)nxt.pn * tstep : cB;
        for (int t = 0; t < nt; t += 2) {
            const bool last = (t == nt - 2);
            const char* a1 = cA + (size_t)(t + 1) * kstep;
            const char* a2 = last ? nA : cA + (size_t)(t + 2) * kstep; const char* b2 = last ? nB : cB + (size_t)(t + 2) * kstep;
            const char* a3 = a2 + kstep; const char* b3 = b2 + kstep;
            if (last && has_next) S.a_ready(nxt);
            if constexpr (SP2) {
            PG8_LDB(B0, 0, 0); PG8_LDB(B1, 0, 1); PG8_SCHED; PG8_LDA(At, 0, 0); PG8_STAGE(PG8_SA(1, 1), a1 + hstep, voffA);
            PG8_WAIT_V(8); PG8_WAIT_L(0); PG8_BAR; PG8_MMA(0, 0, At, B0); PG8_MMA(0, 1, At, B1); PG8_BAR; PG8_SCHED;
            PG8_LDA(At, 0, 1); PG8_STAGE(PG8_SB(0, 0), b2, voffB); PG8_STAGE(PG8_SB(0, 1), b2 + hstep, voffB); PG8_STAGE(PG8_SA(0, 0), a2, voffA);
            PG8_WAIT_V(8); PG8_WAIT_L(0); PG8_BAR; PG8_MMA(1, 0, At, B0); PG8_MMA(1, 1, At, B1); PG8_BAR; PG8_SCHED;
            PG8_LDB(B0, 1, 0); PG8_LDB(B1, 1, 1); PG8_SCHED; PG8_LDA(At, 1, 0); PG8_STAGE(PG8_SA(0, 1), a2 + hstep, voffA);
            PG8_WAIT_V(8); PG8_WAIT_L(0); PG8_BAR; PG8_MMA(0, 0, At, B0); PG8_MMA(0, 1, At, B1); PG8_BAR; PG8_SCHED;
            PG8_LDA(At, 1, 1); PG8_STAGE(PG8_SB(1, 0), b3, voffB); PG8_STAGE(PG8_SB(1, 1), b3 + hstep, voffB); PG8_STAGE(PG8_SA(1, 0), a3, voffA);
            PG8_WAIT_V(8); PG8_WAIT_L(0); PG8_BAR; PG8_MMA(1, 0, At, B0); PG8_MMA(1, 1, At, B1); PG8_BAR; PG8_SCHED;
            } else {
            PG8_LDB(B0, 0, 0); PG8_SCHED; PG8_LDA(At, 0, 0); PG8_STAGE(PG8_SA(1, 1), a1 + hstep, voffA);
            PG8_WAIT_L(8); PG8_BAR; PG8_WAIT_L(0); PG8_MMA(0, 0, At, B0); PG8_BAR; PG8_SCHED;
            PG8_LDB(B1, 0, 1); PG8_STAGE(PG8_SB(0, 0), b2, voffB);
            PG8_BAR; PG8_WAIT_L(0); PG8_MMA(0, 1, At, B1); PG8_BAR;
            PG8_LDA(At, 0, 1); PG8_STAGE(PG8_SA(0, 0), a2, voffA);
            PG8_BAR; PG8_WAIT_L(0); PG8_MMA(1, 0, At, B0); PG8_BAR; PG8_SCHED;
            PG8_STAGE(PG8_SB(0, 1), b2 + hstep, voffB);
            PG8_WAIT_V(6); PG8_BAR; PG8_MMA(1, 1, At, B1); PG8_BAR;
            PG8_LDB(B0, 1, 0); PG8_SCHED; PG8_LDA(At, 1, 0); PG8_STAGE(PG8_SA(0, 1), a2 + hstep, voffA);
            PG8_WAIT_L(8); PG8_BAR; PG8_WAIT_L(0); PG8_MMA(0, 0, At, B0); PG8_BAR; PG8_SCHED;
            PG8_LDB(B1, 1, 1); PG8_STAGE(PG8_SB(1, 0), b3, voffB);
            PG8_BAR; PG8_WAIT_L(0); PG8_MMA(0, 1, At, B1); PG8_BAR;
            PG8_LDA(At, 1, 1); PG8_STAGE(PG8_SA(1, 0), a3, voffA);
            PG8_BAR; PG8_WAIT_L(0); PG8_MMA(1, 0, At, B0); PG8_BAR; PG8_SCHED;
            PG8_STAGE(PG8_SB(1, 1), b3 + hstep, voffB);
            PG8_WAIT_V(6); PG8_BAR; PG8_MMA(1, 1, At, B1); PG8_BAR;
            }
        }
        if constexpr (ALIGN_EPI) { if (wr == 0) PG8_BAR; }
        if constexpr (!Epi::AFTER_DRAIN) { E(acc, cur, wr, wc, fr, fq); S.done(cur); }
        if (!has_next) break;
#pragma unroll
        for (int a = 0; a < 2; ++a)
#pragma unroll
            for (int b = 0; b < 2; ++b)
#pragma unroll
                for (int m = 0; m < 4; ++m)
#pragma unroll
                    for (int n = 0; n < 2; ++n) acc[a][b][m][n] = (f32x4){0.f, 0.f, 0.f, 0.f};
        cur = nxt; cA = nA; cB = nB; ++ui;
        if constexpr (ALIGN_EPI) { if (wr == 1) PG8_BAR; }
    }
    PG8_WAIT_V(0);
    if constexpr (!ALIGN_EPI) { if (wr == 0) PG8_BAR; }
    PG8_BAR;
    if constexpr (Epi::AFTER_DRAIN) { E.fused(acc, cur, wr, wc, fr, fq, lds, wid, lane); S.done(cur); }
#undef PG8_SA
#undef PG8_SB
#undef PG8_STAGE
#undef PG8_LDA
#undef PG8_LDB
#undef PG8_MMA
#undef PG8_WAIT_V
#undef PG8_WAIT_L
#undef PG8_BAR
#undef PG8_SCHED
}
}
#define GAS __attribute__((address_space(1)))
#define LAS __attribute__((address_space(3)))
typedef unsigned short bf16;
typedef unsigned v4u __attribute__((ext_vector_type(4)));
typedef float f32x4 __attribute__((ext_vector_type(4)));
typedef short bf16x8 __attribute__((ext_vector_type(8)));
typedef GAS unsigned gu32;
typedef GAS unsigned long long gu64;
#define RLX_AGENT __ATOMIC_RELAXED, __HIP_MEMORY_SCOPE_AGENT
#define LDS_WAIT() asm volatile("s_waitcnt lgkmcnt(0)" ::: "memory")
#define VM_WAIT() asm volatile("s_waitcnt vmcnt(0)" ::: "memory")
__device__ __forceinline__ unsigned long long rt() { return __builtin_amdgcn_s_memrealtime(); }
__device__ __forceinline__ unsigned f2bf(float f) { unsigned u = __builtin_bit_cast(unsigned, f); return (u + 0x7fffu + ((u >> 16) & 1u)) >> 16; }
__device__ __forceinline__ unsigned pk2(float lo, float hi) { return f2bf(lo) | (f2bf(hi) << 16); }

#define XB_TMO      128
#define XB_XCNT(j)  (256  + 64 * (j))
#define XB_XSUB(j)  (1280 + 64 * (j))
#define XB_XGEN(j)  (2304 + 64 * (j))
#define XB_TOP      3328
#define XB_TOPGEN   3392
#define XCD_BAR_WORDS 3456
#define XB_SPIN_CAP (1u << 18)

__device__ __forceinline__ unsigned xb_ld(unsigned* p)              { return __hip_atomic_load(p, __ATOMIC_RELAXED, __HIP_MEMORY_SCOPE_AGENT); }
__device__ __forceinline__ unsigned xb_add(unsigned* p, unsigned v) { return __hip_atomic_fetch_add(p, v, __ATOMIC_RELAXED, __HIP_MEMORY_SCOPE_AGENT); }
__device__ __forceinline__ unsigned xb_xcc_id() { return (unsigned)__builtin_amdgcn_s_getreg((3 << 11) | 20) & 0xFu; }
#define XB_SPIN(cond, bar) do { unsigned _sp = 0; while (cond) { __builtin_amdgcn_s_sleep(1); \
    if ((++_sp & 255u) == 0u) { if (xb_ld(&(bar)[XB_TMO])) break; if (_sp > XB_SPIN_CAP) { atomicAdd(&(bar)[XB_TMO], 1u); break; } } } } while (0)

struct XcdBarrier {
    unsigned* bar; unsigned x;
    volatile LAS unsigned* st;
};

__device__ __forceinline__ XcdBarrier xcd_barrier_post(unsigned* bar, volatile LAS unsigned* st) {
    XcdBarrier b; b.bar = bar; b.x = xb_xcc_id(); b.st = st;
    if (threadIdx.x == 0) (void)xb_add(&bar[XB_XCNT(b.x)], 1u);
    return b;
}
__device__ __forceinline__ void xcd_barrier_complete(unsigned* bar, unsigned x, unsigned& nloc, unsigned& nx) {
    const unsigned G = gridDim.x * gridDim.y * gridDim.z;
    unsigned sum, cnt, mine, sp = 0u;
    for (;;) {
        sum = 0u; cnt = 0u; mine = 0u;
#pragma unroll
        for (unsigned j = 0; j < 16; ++j) { const unsigned c = xb_ld(&bar[XB_XCNT(j)]); sum += c; cnt += (c > 0u) ? 1u : 0u; mine = (j == x) ? c : mine; }
        if (sum == G) break;
        __builtin_amdgcn_s_sleep(1);
        if ((++sp & 255u) == 0u) { if (xb_ld(&bar[XB_TMO])) break; if (sp > XB_SPIN_CAP) { atomicAdd(&bar[XB_TMO], 1u); break; } }
    }
    nloc = mine > 0u ? mine : 1u; nx = cnt > 0u ? cnt : 1u;
}

__device__ __forceinline__ void xcd_barrier(const XcdBarrier& b) {
    asm volatile("s_waitcnt vmcnt(0)" ::: "memory");
    __syncthreads();
    if (threadIdx.x == 0) {
        unsigned* bar = b.bar;
        __builtin_amdgcn_s_waitcnt(0);
        unsigned nloc = b.st[0], nx = b.st[1];
        if (nloc == 0u) { xcd_barrier_complete(bar, b.x, nloc, nx); b.st[0] = nloc; b.st[1] = nx; }
        const unsigned old = xb_add(&bar[XB_XSUB(b.x)], 1u);
        const unsigned gen = old / nloc;
        if (old + 1u == (gen + 1u) * nloc) {
            __builtin_amdgcn_fence(__ATOMIC_RELEASE, "agent");
            asm volatile("s_waitcnt vmcnt(0)" ::: "memory");
            const unsigned og = xb_add(&bar[XB_TOP], 1u);
            const unsigned tg = og / nx;
            if (og + 1u == (tg + 1u) * nx) xb_add(&bar[XB_TOPGEN], 1u);
            else XB_SPIN(xb_ld(&bar[XB_TOPGEN]) == tg, bar);
            __builtin_amdgcn_fence(__ATOMIC_ACQUIRE, "agent");
            xb_add(&bar[XB_XGEN(b.x)], 1u);
            asm volatile("s_waitcnt vmcnt(0)" ::: "memory");
        } else {
            XB_SPIN(xb_ld(&bar[XB_XGEN(b.x)]) == gen, bar);
            __builtin_amdgcn_fence(__ATOMIC_ACQUIRE, "agent");
            asm volatile("s_waitcnt vmcnt(0)" ::: "memory");
        }
    }
    __syncthreads();
}

constexpr int NWAVES = 8;
constexpr int NB = 4, SEQ = 8192, DM = 1024;
constexpr int LP = SEQ + 32;
constexpr int NT32 = LP / 32;
constexpr int MT = NB * SEQ;
constexpr int M1 = MT + 256;
constexpr int NCOL = 6400;
constexpr int SBH = 8, SWH = 16, SWKV = 2;
constexpr float RMS_EPS = 1e-6f;
constexpr float LOG2E = 1.4426950408889634f;
constexpr float C2 = 0.125f * LOG2E;
constexpr float SB_EXIT = -160.0f;

typedef unsigned u32x2 __attribute__((ext_vector_type(2)));
typedef unsigned u32x4 __attribute__((ext_vector_type(4)));
typedef float f32x2 __attribute__((ext_vector_type(2)));
typedef float f32x16 __attribute__((ext_vector_type(16)));
typedef _Float16 f16x8 __attribute__((ext_vector_type(8)));
typedef _Float16 f16x2 __attribute__((ext_vector_type(2)));
typedef __bf16 bfx2 __attribute__((ext_vector_type(2)));

constexpr size_t MiB = 1u << 20;
constexpr size_t WS_CTL = 0, CTL_ZERO_BYTES = 1 * MiB;
constexpr int CW_BAR = 4096;
constexpr size_t WS_ROWSS = 512 * 1024;
constexpr size_t WS_ROPE = 1 * MiB;
constexpr size_t WS_WIN = 4 * MiB;
constexpr size_t WS_WSB = 17 * MiB;
constexpr size_t WS_WSW = 18 * MiB;
constexpr size_t WS_WOUT = 20 * MiB;
constexpr size_t WS_XN = 22 * MiB;
constexpr size_t WS_SBQ = 87 * MiB;
constexpr size_t WS_SBK = 120 * MiB;
constexpr size_t WS_SBV = 153 * MiB;
constexpr size_t WS_SWQ = 186 * MiB;
constexpr size_t WS_SWK = 251 * MiB;
constexpr size_t WS_SWV = 260 * MiB;
constexpr size_t WS_SZSB = 269 * MiB;
constexpr size_t WS_SZSW = 301 * MiB;
constexpr size_t WS_GSB = 365 * MiB;
constexpr size_t WS_GSW = 429 * MiB;
constexpr size_t WS_END = 493 * MiB;
constexpr size_t WS_T = WS_XN, WS_MERGED = WS_SBQ;
static_assert(WS_XN + (size_t)M1 * DM * 2 <= WS_SBQ && WS_SBQ + (size_t)NB * SBH * NT32 * 4096 <= WS_SBK && WS_SWQ + (size_t)NB * SWH * NT32 * 4096 <= WS_SWK && WS_SWK + (size_t)NB * SWKV * NT32 * 4096 <= WS_SWV, "ws map");
static_assert(WS_MERGED + (size_t)MT * DM * 2 <= WS_SBV && WS_WIN + (size_t)NCOL * DM * 2 <= WS_WSB, "ws map");

constexpr int RING_OFF = 0, RING_BYTES = 131072;
constexpr int LDSCTL_OFF = RING_BYTES, MISC_OFF = LDSCTL_OFF + 320;
constexpr int LDS_BYTES = 147456;

struct Ptrs {
    const float *x, *meta, *gain, *w_in, *w_sb, *w_sw, *w_out, *sinks, *fgain;
    float* out; unsigned char* ws;
    float inv[32];
};

__device__ __forceinline__ float bf2f(bf16 b) { return __builtin_bit_cast(float, (unsigned)b << 16); }
__device__ __forceinline__ float bflo(unsigned w) { return __builtin_bit_cast(float, w << 16); }
__device__ __forceinline__ float bfhi(unsigned w) { return __builtin_bit_cast(float, w & 0xffff0000u); }
__device__ __forceinline__ unsigned cvt2bf(float lo, float hi) { f32x2 v = {lo, hi}; return __builtin_bit_cast(unsigned, __builtin_convertvector(v, bfx2)); }
__device__ __forceinline__ unsigned cvt2h(float lo, float hi) { f32x2 v = {lo, hi}; return __builtin_bit_cast(unsigned, __builtin_convertvector(v, f16x2)); }

__device__ __forceinline__ size_t ft_chunk(int bh, int lp, int d8) { return ((size_t)(bh * NT32 + (lp >> 5)) * 2048) + (d8 >> 1) * 512 + (d8 & 1) * 256 + (lp & 31) * 8; }
__device__ __forceinline__ size_t vt_elem(int bh, int lp, int d) {
    const int kk = lp & 31, s = kk >> 4, w = kk & 15, hi = (w >> 2) & 1, e = ((w >> 3) << 2) | (w & 3), dt = d >> 5, dl = d & 31;
    return (size_t)(bh * NT32 + (lp >> 5)) * 2048 + (size_t)(((dt * 2 + s) * 64) + dl + 32 * hi) * 8 + e;
}
__host__ __device__ __forceinline__ int orig_col0(int pn, int bj, int wc) {
    if (pn < 2) return 0 + (4 * pn + wc) * 64 + 32 * bj;
    if (pn < 4) return 512 + (4 * (pn - 2) + wc) * 64 + 32 * bj;
    if (pn < 6) return 1024 + (4 * (pn - 4) + wc) * 64 + 32 * bj;
    if (pn < 10) return 1536 + (4 * (pn - 6) + wc) * 64 + 32 * bj;
    if (pn == 10) return wc < 2 ? 2560 + wc * 64 + 32 * bj : 2688 + (wc - 2) * 64 + 32 * bj;
    if (pn < 13) return 2816 + (pn - 11) * 256 + 128 * bj + 32 * wc;
    if (pn < 17) return 3328 + (pn - 13) * 256 + 128 * bj + 32 * wc;
    if (pn < 21) return 4352 + (pn - 17) * 256 + 128 * bj + 32 * wc;
    return 5376 + (pn - 21) * 256 + 128 * bj + 32 * wc;
}

__device__ __forceinline__ void store_vt8(bf16* base, int bh, int lp, int d0, const float (&v)[8]) {
    bf16* p = base + vt_elem(bh, lp, d0);
#pragma unroll
    for (int j = 0; j < 8; ++j) p[j * 8] = (bf16)f2bf(v[j]);
}
__device__ __forceinline__ v4u pack8(const float (&v)[8]) { v4u w; w.x = cvt2bf(v[0], v[1]); w.y = cvt2bf(v[2], v[3]); w.z = cvt2bf(v[4], v[5]); w.w = cvt2bf(v[6], v[7]); return w; }
__device__ __forceinline__ float sigm_f(float z) { return __builtin_amdgcn_rcpf(1.f + __builtin_amdgcn_exp2f(-z * LOG2E)); }
__device__ __forceinline__ float silu_f(float z) { return z * sigm_f(z); }

__device__ __forceinline__ void epi_row(unsigned char* ws, int row, int pn, int wc, int fq, float (&v0)[8], float (&v1)[8]) {
    const bool meta = row >= MT;
    const int mr = row - MT;
    if (meta && mr >= 32) return;
    const int b = row >> 13, t = row & (SEQ - 1);
    const int lp = meta ? mr : 32 + t;
    const int i0 = 8 * fq;
    if (pn < 11) {
        const bool rope = (pn >= 6 && pn < 10) || (pn == 10 && wc < 2);
        if (rope) {
            const f32x4* tab = (const f32x4*)((const float2*)(ws + WS_ROPE) + (size_t)lp * 32 + i0);
#pragma unroll
            for (int j = 0; j < 4; ++j) { const f32x4 cs = tab[j];
                { const float a = v0[2 * j], c = v1[2 * j]; v0[2 * j] = a * cs.x - c * cs.y; v1[2 * j] = c * cs.x + a * cs.y; }
                { const float a = v0[2 * j + 1], c = v1[2 * j + 1]; v0[2 * j + 1] = a * cs.z - c * cs.w; v1[2 * j + 1] = c * cs.z + a * cs.w; } }
        }
        const bool isq = pn < 2 || (pn >= 6 && pn < 10);
        if (isq) {
#pragma unroll
            for (int j = 0; j < 8; ++j) { v0[j] *= C2; v1[j] *= C2; }
        }
        bf16* base; int head, nh; bool isv = false;
        if (pn < 2) { base = (bf16*)(ws + WS_SBQ); head = 4 * pn + wc; nh = SBH; }
        else if (pn < 4) { base = (bf16*)(ws + WS_SBK); head = 4 * (pn - 2) + wc; nh = SBH; }
        else if (pn < 6) { base = (bf16*)(ws + WS_SBV); head = 4 * (pn - 4) + wc; nh = SBH; isv = true; }
        else if (pn < 10) { base = (bf16*)(ws + WS_SWQ); head = 4 * (pn - 6) + wc; nh = SWH; }
        else if (wc < 2) { base = (bf16*)(ws + WS_SWK); head = wc; nh = SWKV; }
        else { base = (bf16*)(ws + WS_SWV); head = wc - 2; nh = SWKV; isv = true; }
        if (meta && isq) return;
        const int nb = meta ? NB : 1;
        for (int bb = 0; bb < nb; ++bb) {
            const int bh = (meta ? bb : b) * nh + head;
            if (isv) { store_vt8(base, bh, lp, i0, v0); store_vt8(base, bh, lp, 32 + i0, v1); }
            else { *(v4u*)(base + ft_chunk(bh, lp, fq)) = pack8(v0); *(v4u*)(base + ft_chunk(bh, lp, 4 + fq)) = pack8(v1); }
        }
        return;
    }
    if (meta) return;
    bf16* base; int ld, ct;
    if (pn < 13) { base = (bf16*)(ws + WS_SZSB); ld = 512; ct = pn - 11; }
    else if (pn < 17) { base = (bf16*)(ws + WS_SZSW); ld = 1024; ct = pn - 13; }
    else if (pn < 21) { base = (bf16*)(ws + WS_GSB); ld = 1024; ct = pn - 17; }
    else { base = (bf16*)(ws + WS_GSW); ld = 1024; ct = pn - 21; }
    if (pn < 17) {
#pragma unroll
        for (int j = 0; j < 8; ++j) { v0[j] = silu_f(v0[j]); v1[j] = silu_f(v1[j]); }
    } else {
#pragma unroll
        for (int j = 0; j < 8; ++j) { v0[j] = sigm_f(v0[j]); v1[j] = sigm_f(v1[j]); }
    }
    bf16* rp = base + (size_t)row * ld + ct * 256 + 32 * wc + i0;
    *(v4u*)rp = pack8(v0); *(v4u*)(rp + 128) = pack8(v1);
}

namespace pg8 {
#define PG8_V8(dst, a0, a1) float dst[8] = {a0[0], a0[1], a0[2], a0[3], a1[0], a1[1], a1[2], a1[3]}
struct EpiG1 {
    static constexpr bool PERM = true, AFTER_DRAIN = false;
    unsigned char* ws;
    __device__ __forceinline__ void operator()(const f32x4 (&acc)[2][2][4][2], const Unit& u, int wr, int wc, int fr, int fq) const {
#pragma unroll
        for (int ai = 0; ai < 2; ++ai)
#pragma unroll
            for (int m = 0; m < 4; ++m) { const int row = u.pm * BM + ai * HALF + wr * 64 + m * 16 + fr;
                PG8_V8(v0, acc[ai][0][m][0], acc[ai][0][m][1]); PG8_V8(v1, acc[ai][1][m][0], acc[ai][1][m][1]);
                epi_row(ws, row, u.pn, wc, fq, v0, v1); }
    }
};
template <int MODE  > struct EpiGate {
    static constexpr bool PERM = true, AFTER_DRAIN = false;
    const bf16_t* G; const bf16_t* Tin; bf16_t* O;
    __device__ __forceinline__ void operator()(const f32x4 (&acc)[2][2][4][2], const Unit& u, int wr, int wc, int fr, int fq) const {
#pragma unroll
        for (int ai = 0; ai < 2; ++ai)
#pragma unroll
            for (int m = 0; m < 4; ++m) { const size_t off = (size_t)(u.pm * BM + ai * HALF + wr * 64 + m * 16 + fr) * 1024 + u.pn * BM + wc * 32 + 8 * fq;
#pragma unroll
                for (int bj = 0; bj < 2; ++bj) { const u32x4 g = *(const u32x4*)(G + off + bj * HALF); const f32x4 a0 = acc[ai][bj][m][0], a1 = acc[ai][bj][m][1];
                    float r[8] = {a0[0] * bflo(g.x), a0[1] * bfhi(g.x), a0[2] * bflo(g.y), a0[3] * bfhi(g.y), a1[0] * bflo(g.z), a1[1] * bfhi(g.z), a1[2] * bflo(g.w), a1[3] * bfhi(g.w)};
                    if (MODE == 1) { const u32x4 tq = *(const u32x4*)(Tin + off + bj * HALF);
                        r[0] += bflo(tq.x); r[1] += bfhi(tq.x); r[2] += bflo(tq.y); r[3] += bfhi(tq.y); r[4] += bflo(tq.z); r[5] += bfhi(tq.z); r[6] += bflo(tq.w); r[7] += bfhi(tq.w); }
                    u32x4 w; w.x = cvt_pk_bf16(r[0], r[1]); w.y = cvt_pk_bf16(r[2], r[3]); w.z = cvt_pk_bf16(r[4], r[5]); w.w = cvt_pk_bf16(r[6], r[7]);
                    *(u32x4*)(O + off + bj * HALF) = w; } }
    }
};
struct EpiOut {
    static constexpr bool PERM = true, AFTER_DRAIN = false;
    const float* X; float* O; float* rowss;
    __device__ __forceinline__ void operator()(const f32x4 (&acc)[2][2][4][2], const Unit& u, int wr, int wc, int fr, int fq) const {
#pragma unroll
        for (int ai = 0; ai < 2; ++ai)
#pragma unroll
            for (int m = 0; m < 4; ++m) { const int row = u.pm * BM + ai * HALF + wr * 64 + m * 16 + fr; const size_t off = (size_t)row * 1024 + u.pn * BM + wc * 32 + 8 * fq; float ss = 0.f;
#pragma unroll
                for (int bj = 0; bj < 2; ++bj)
#pragma unroll
                    for (int n = 0; n < 2; ++n) { const f32x4 h = *(const f32x4*)(X + off + bj * HALF + 4 * n) + acc[ai][bj][m][n];
                        ss += (h[0] * h[0] + h[1] * h[1]) + (h[2] * h[2] + h[3] * h[3]); *(f32x4*)(O + off + bj * HALF + 4 * n) = h; }
                ss += __shfl_xor(ss, 16); ss += __shfl_xor(ss, 32);
                if (fq == 0) unsafeAtomicAdd(rowss + row, ss); }
    }
};
}

__device__ __forceinline__ float wave_sum(float v) {
#pragma unroll
    for (int o = 1; o < 64; o <<= 1) v += __shfl_xor(v, o);
    return v;
}
__device__ __forceinline__ void p0_transpose_item(const float* W, int K, int N, bf16* WT, int k0, int c0, int row0, LAS float* scr, int lane) {
#pragma unroll 8
    for (int i = 0; i < 32; ++i) { const int kk = 2 * i + (lane >> 5); scr[kk * 33 + (lane & 31)] = W[(size_t)(k0 + kk) * N + c0 + (lane & 31)]; }
    LDS_WAIT(); asm volatile("" ::: "memory");
    const int c = lane & 7;
#pragma unroll
    for (int j = 0; j < 4; ++j) { const int n = (lane >> 3) + 8 * j; const LAS float* s = scr + (8 * c) * 33 + n;
        v4u o; o.x = pk2(s[0 * 33], s[1 * 33]); o.y = pk2(s[2 * 33], s[3 * 33]); o.z = pk2(s[4 * 33], s[5 * 33]); o.w = pk2(s[6 * 33], s[7 * 33]);
        *(GAS v4u*)(WT + (size_t)(row0 + n) * K + k0 + 8 * c) = o; }
    LDS_WAIT(); asm volatile("" ::: "memory");
}
__device__ __forceinline__ void rms_row_to_bf16(const float* src, const float* gain, bf16* dst, int lane) {
    unsigned long long* o8 = (unsigned long long*)dst + lane;
    if (!src) {
#pragma unroll
        for (int j = 0; j < 4; ++j) o8[64 * j] = 0ull;
        return; }
    const f32x4* xr = (const f32x4*)src + lane; const f32x4* gr = (const f32x4*)gain + lane;
    f32x4 v[4]; float s = 0.f;
#pragma unroll
    for (int j = 0; j < 4; ++j) { v[j] = xr[64 * j]; s += (v[j].x * v[j].x + v[j].y * v[j].y) + (v[j].z * v[j].z + v[j].w * v[j].w); }
    const float rstd = 1.0f / sqrtf(wave_sum(s) * (1.f / DM) + RMS_EPS);
#pragma unroll
    for (int j = 0; j < 4; ++j) { const f32x4 g = gr[64 * j];
        o8[64 * j] = (unsigned long long)pk2(v[j].x * rstd * g.x, v[j].y * rstd * g.y) | ((unsigned long long)pk2(v[j].z * rstd * g.z, v[j].w * rstd * g.w) << 32); }
}
__device__ __forceinline__ void sincos_d(double x, double& s, double& c) {
    const double k = rint(x * 0.63661977236758134308);
    double r = fma(-k, 1.57079632679489655800e+00, x); r = fma(-k, 6.12323399573676603587e-17, r);
    const double r2 = r * r;
    double sp = -7.6471637318198164759e-13; sp = fma(sp, r2, 1.6059043836821614599e-10); sp = fma(sp, r2, -2.5052108385441718775e-08); sp = fma(sp, r2, 2.7557319223985890653e-06);
    sp = fma(sp, r2, -1.9841269841269841270e-04); sp = fma(sp, r2, 8.3333333333333333333e-03); sp = fma(sp, r2, -1.6666666666666666667e-01); const double sn = fma(sp * r2, r, r);
    double cp = 4.7794773323873852974e-14; cp = fma(cp, r2, -1.1470745597729724714e-11); cp = fma(cp, r2, 2.0876756987868098979e-09); cp = fma(cp, r2, -2.7557319223985890653e-07);
    cp = fma(cp, r2, 2.4801587301587301587e-05); cp = fma(cp, r2, -1.3888888888888888889e-03); cp = fma(cp, r2, 4.1666666666666666667e-02); cp = fma(cp, r2, -0.5); const double cn = fma(cp, r2, 1.0);
    const int q = ((int)k) & 3;
    s = (q == 0) ? sn : (q == 1) ? cn : (q == 2) ? -sn : -cn;
    c = (q == 0) ? cn : (q == 1) ? -sn : (q == 2) ? -cn : sn;
}

struct Ctx { LAS unsigned char* lds; int tid, lane, wave, vcu, G; };

__device__ __forceinline__ void p0_prologue(const Ptrs& P, const Ctx& F) {
    LAS float* scr = (LAS float*)(F.lds + RING_OFF + F.wave * 16384);
    const int gw = F.vcu * NWAVES + F.wave, NGW = F.G * NWAVES;
    constexpr int I_IN = (DM / 64) * (NCOL / 32), I_SB = (512 / 64) * (DM / 32), I_SW = (DM / 64) * (DM / 32), I_OUT = I_SW;
    constexpr int NITEMS = I_IN + I_SB + I_SW + I_OUT;
    for (int it = gw; it < NITEMS; it += NGW) {
        int r = it;
        if (r < I_IN) { const int nb = r % (NCOL / 32), kb = r / (NCOL / 32); const int c0 = orig_col0(nb >> 3, (nb >> 2) & 1, nb & 3);
            p0_transpose_item(P.w_in, DM, NCOL, (bf16*)(P.ws + WS_WIN), 64 * kb, c0, 32 * nb, scr, F.lane); continue; } r -= I_IN;
        if (r < I_SB) { const int nb = r % (DM / 32), kb = r / (DM / 32); p0_transpose_item(P.w_sb, 512, DM, (bf16*)(P.ws + WS_WSB), 64 * kb, 32 * nb, 32 * nb, scr, F.lane); continue; } r -= I_SB;
        if (r < I_SW) { const int nb = r % (DM / 32), kb = r / (DM / 32); p0_transpose_item(P.w_sw, DM, DM, (bf16*)(P.ws + WS_WSW), 64 * kb, 32 * nb, 32 * nb, scr, F.lane); continue; } r -= I_SW;
        { const int nb = r % (DM / 32), kb = r / (DM / 32); p0_transpose_item(P.w_out, DM, DM, (bf16*)(P.ws + WS_WOUT), 64 * kb, 32 * nb, 32 * nb, scr, F.lane); }
    }
    bf16* XN = (bf16*)(P.ws + WS_XN);
    for (int m = gw; m < M1; m += NGW) {
        const float* src = nullptr;
        if (m < MT) src = P.x + (size_t)m * DM; else { const int r = m - MT; if (r >= 16 && r < 32) src = P.meta + (size_t)(r - 16) * DM; }
        rms_row_to_bf16(src, P.gain, XN + (size_t)m * DM, F.lane);
    }
    float2* tab = (float2*)(P.ws + WS_ROPE);
    for (int e = gw * 64 + F.lane; e < LP * 32; e += NGW * 64) {
        const int lp = e >> 5, i = e & 31; float2 cs = make_float2(1.f, 0.f);
        if (lp >= 16) { const float ang = (float)(lp - 16) * P.inv[i]; double s, c; sincos_d((double)ang, s, c); cs = make_float2((float)c, (float)s); }
        tab[e] = cs;
    }
}

#define MFMA_BF16(a, b, c) __builtin_amdgcn_mfma_f32_32x32x16_bf16((a), (b), (c), 0, 0, 0)
#define MFMA_F16(a, b, c) __builtin_amdgcn_mfma_f32_32x32x16_f16((a), (b), (c), 0, 0, 0)
__device__ __forceinline__ int crow(int r, int hi) { return (r & 3) + 8 * (r >> 2) + 4 * hi; }

__device__ __forceinline__ void sb_unit(unsigned char* ws, int bh, int T, int lane) {
    const int r32 = lane & 31, hi = lane >> 5;
    const bf16x8* Qp = (const bf16x8*)(ws + WS_SBQ) + (size_t)(bh * NT32 + T) * 256 + lane;
    bf16x8 qf[4];
#pragma unroll
    for (int ks = 0; ks < 4; ++ks) qf[ks] = Qp[ks * 64];
    f16x8 tm[2], ones;
#pragma unroll
    for (int s = 0; s < 2; ++s)
#pragma unroll
        for (int e = 0; e < 8; ++e) tm[s][e] = (16 * s + 8 * (e >> 2) + 4 * hi + (e & 3) > r32) ? (_Float16)1.0f : (_Float16)0.0f;
#pragma unroll
    for (int e = 0; e < 8; ++e) ones[e] = (_Float16)1.0f;
    f32x16 o0, o1, Rb;
#pragma unroll
    for (int i = 0; i < 16; ++i) { o0[i] = 0.f; o1[i] = 0.f; Rb[i] = 0.f; }
    for (int kt = T; kt >= 0; --kt) {
        const bf16x8* Kp = (const bf16x8*)(ws + WS_SBK) + (size_t)(bh * NT32 + kt) * 256 + lane;
        const bf16x8* Vp = (const bf16x8*)(ws + WS_SBV) + (size_t)(bh * NT32 + kt) * 256 + lane;
        bf16x8 kf[4], vf[4];
#pragma unroll
        for (int ks = 0; ks < 4; ++ks) { kf[ks] = Kp[ks * 64]; vf[ks] = Vp[ks * 64]; }
        f32x16 S;
#pragma unroll
        for (int i = 0; i < 16; ++i) S[i] = 0.f;
#pragma unroll
        for (int ks = 0; ks < 4; ++ks) S = MFMA_BF16(kf[ks], qf[ks], S);
        const bool diag = (kt == T), first = (kt == 0);
        f32x16 C; float l1[16];
#pragma unroll
        for (int i = 0; i < 16; ++i) {
            const float z = S[i];
            const float l = __builtin_amdgcn_logf(1.f + __builtin_amdgcn_exp2f(-__builtin_fabsf(z)));
            float lb = __builtin_fminf(z, 0.f) - l;
            float lm = lb - z;
            if (diag || first) { const int key = crow(i, hi); const bool ok = diag ? (key < r32) : (key >= 16); lb = ok ? lb : -INFINITY; lm = ok ? lm : 0.f; }
            C[i] = lb + Rb[i]; l1[i] = lm;
        }
        u32x4 L0, L1;
        L0.x = cvt2h(l1[0], l1[1]); L0.y = cvt2h(l1[2], l1[3]); L0.z = cvt2h(l1[4], l1[5]); L0.w = cvt2h(l1[6], l1[7]);
        L1.x = cvt2h(l1[8], l1[9]); L1.y = cvt2h(l1[10], l1[11]); L1.z = cvt2h(l1[12], l1[13]); L1.w = cvt2h(l1[14], l1[15]);
        const f16x8 l0h = __builtin_bit_cast(f16x8, L0), l1h = __builtin_bit_cast(f16x8, L1);
        C = MFMA_F16(tm[0], l0h, C); C = MFMA_F16(tm[1], l1h, C);
        Rb = MFMA_F16(ones, l0h, Rb); Rb = MFMA_F16(ones, l1h, Rb);
        u32x4 P0, P1;
        P0.x = cvt2bf(__builtin_amdgcn_exp2f(C[0]), __builtin_amdgcn_exp2f(C[1])); P0.y = cvt2bf(__builtin_amdgcn_exp2f(C[2]), __builtin_amdgcn_exp2f(C[3]));
        P0.z = cvt2bf(__builtin_amdgcn_exp2f(C[4]), __builtin_amdgcn_exp2f(C[5])); P0.w = cvt2bf(__builtin_amdgcn_exp2f(C[6]), __builtin_amdgcn_exp2f(C[7]));
        P1.x = cvt2bf(__builtin_amdgcn_exp2f(C[8]), __builtin_amdgcn_exp2f(C[9])); P1.y = cvt2bf(__builtin_amdgcn_exp2f(C[10]), __builtin_amdgcn_exp2f(C[11]));
        P1.z = cvt2bf(__builtin_amdgcn_exp2f(C[12]), __builtin_amdgcn_exp2f(C[13])); P1.w = cvt2bf(__builtin_amdgcn_exp2f(C[14]), __builtin_amdgcn_exp2f(C[15]));
        const bf16x8 p0 = __builtin_bit_cast(bf16x8, P0), p1 = __builtin_bit_cast(bf16x8, P1);
        o0 = MFMA_BF16(vf[0], p0, o0); o0 = MFMA_BF16(vf[1], p1, o0);
        o1 = MFMA_BF16(vf[2], p0, o1); o1 = MFMA_BF16(vf[3], p1, o1);
        if (__all(Rb[0] < SB_EXIT)) break;
    }
    const int b = bh >> 3, h = bh & 7;
    bf16* A = (bf16*)(ws + WS_SZSB) + (size_t)(b * SEQ + 32 * (T - 1) + r32) * 512 + h * 64 + 4 * hi;
#pragma unroll
    for (int g = 0; g < 4; ++g) {
        { u32x2* p = (u32x2*)(A + 8 * g); const u32x2 z = *p; u32x2 w; w.x = cvt2bf(o0[4 * g] * bflo(z.x), o0[4 * g + 1] * bfhi(z.x)); w.y = cvt2bf(o0[4 * g + 2] * bflo(z.y), o0[4 * g + 3] * bfhi(z.y)); *p = w; }
        { u32x2* p = (u32x2*)(A + 32 + 8 * g); const u32x2 z = *p; u32x2 w; w.x = cvt2bf(o1[4 * g] * bflo(z.x), o1[4 * g + 1] * bfhi(z.x)); w.y = cvt2bf(o1[4 * g + 2] * bflo(z.y), o1[4 * g + 3] * bfhi(z.y)); *p = w; }
    }
}

__device__ __forceinline__ void sw_unit(unsigned char* ws, const float* sinks, int bh, int T, int lane) {
    const int r32 = lane & 31, hi = lane >> 5;
    const int b = bh >> 4, h = bh & 15, bkv = b * SWKV + (h >> 3);
    const bf16x8* Qp = (const bf16x8*)(ws + WS_SWQ) + (size_t)(bh * NT32 + T) * 256 + lane;
    bf16x8 qf[4];
#pragma unroll
    for (int ks = 0; ks < 4; ++ks) qf[ks] = Qp[ks * 64];
    const float sink2 = sinks[h] * LOG2E;
    f32x16 S[5]; float mx = sink2;
#pragma unroll
    for (int j = 0; j < 5; ++j) {
        const int kt = T - 4 + j;
        if (kt >= 0) {
            const bf16x8* Kp = (const bf16x8*)(ws + WS_SWK) + (size_t)(bkv * NT32 + kt) * 256 + lane;
            bf16x8 kf[4];
#pragma unroll
            for (int ks = 0; ks < 4; ++ks) kf[ks] = Kp[ks * 64];
            f32x16 s;
#pragma unroll
            for (int i = 0; i < 16; ++i) s[i] = 0.f;
#pragma unroll
            for (int ks = 0; ks < 4; ++ks) s = MFMA_BF16(kf[ks], qf[ks], s);
            if (j == 0 || j == 4 || kt == 0) {
#pragma unroll
                for (int i = 0; i < 16; ++i) { const int key = crow(i, hi); bool ok = true; if (j == 4) ok = key <= r32; if (j == 0) ok = key > r32; if (kt == 0) ok = ok && key >= 16; s[i] = ok ? s[i] : -INFINITY; }
            }
#pragma unroll
            for (int i = 0; i < 16; ++i) mx = __builtin_fmaxf(mx, s[i]);
            S[j] = s;
        }
    }
    mx = __builtin_fmaxf(mx, __shfl_xor(mx, 32));
    float den = 0.f; f32x16 o0, o1;
#pragma unroll
    for (int i = 0; i < 16; ++i) { o0[i] = 0.f; o1[i] = 0.f; }
#pragma unroll
    for (int j = 0; j < 5; ++j) {
        const int kt = T - 4 + j;
        if (kt >= 0) {
            const bf16x8* Vp = (const bf16x8*)(ws + WS_SWV) + (size_t)(bkv * NT32 + kt) * 256 + lane;
            bf16x8 vf[4];
#pragma unroll
            for (int ks = 0; ks < 4; ++ks) vf[ks] = Vp[ks * 64];
            float p[16];
#pragma unroll
            for (int i = 0; i < 16; ++i) { p[i] = __builtin_amdgcn_exp2f(S[j][i] - mx); den += p[i]; }
            u32x4 P0, P1;
            P0.x = cvt2bf(p[0], p[1]); P0.y = cvt2bf(p[2], p[3]); P0.z = cvt2bf(p[4], p[5]); P0.w = cvt2bf(p[6], p[7]);
            P1.x = cvt2bf(p[8], p[9]); P1.y = cvt2bf(p[10], p[11]); P1.z = cvt2bf(p[12], p[13]); P1.w = cvt2bf(p[14], p[15]);
            const bf16x8 p0 = __builtin_bit_cast(bf16x8, P0), p1 = __builtin_bit_cast(bf16x8, P1);
            o0 = MFMA_BF16(vf[0], p0, o0); o0 = MFMA_BF16(vf[1], p1, o0);
            o1 = MFMA_BF16(vf[2], p0, o1); o1 = MFMA_BF16(vf[3], p1, o1);
        }
    }
    den += __shfl_xor(den, 32);
    den += __builtin_amdgcn_exp2f(sink2 - mx);
    const float rd = __builtin_amdgcn_rcpf(den);
    bf16* A = (bf16*)(ws + WS_SZSW) + (size_t)(b * SEQ + 32 * (T - 1) + r32) * 1024 + h * 64 + 4 * hi;
#pragma unroll
    for (int g = 0; g < 4; ++g) {
        { u32x2* p = (u32x2*)(A + 8 * g); const u32x2 z = *p; u32x2 w; w.x = cvt2bf(o0[4 * g] * rd * bflo(z.x), o0[4 * g + 1] * rd * bfhi(z.x)); w.y = cvt2bf(o0[4 * g + 2] * rd * bflo(z.y), o0[4 * g + 3] * rd * bfhi(z.y)); *p = w; }
        { u32x2* p = (u32x2*)(A + 32 + 8 * g); const u32x2 z = *p; u32x2 w; w.x = cvt2bf(o1[4 * g] * rd * bflo(z.x), o1[4 * g + 1] * rd * bfhi(z.x)); w.y = cvt2bf(o1[4 * g + 2] * rd * bflo(z.y), o1[4 * g + 3] * rd * bfhi(z.y)); *p = w; }
    }
}

__global__ void __launch_bounds__(NWAVES * 64, 2) mega_fwd(Ptrs P) {
    extern __shared__ __attribute__((aligned(16))) unsigned char lds_raw[];
    Ctx F;
    F.lds = (LAS unsigned char*)lds_raw;
    F.tid = threadIdx.x; F.lane = F.tid & 63; F.wave = __builtin_amdgcn_readfirstlane(F.tid >> 6);
    F.G = gridDim.x; { const int bx = blockIdx.x; F.vcu = (F.G % 8 == 0) ? (bx % 8) * (F.G / 8) + bx / 8 : bx; }
    volatile LAS unsigned* MISC = (volatile LAS unsigned*)(F.lds + MISC_OFF);
    for (int u = F.tid; u < (LDS_BYTES - LDSCTL_OFF) / 4; u += NWAVES * 64) ((LAS unsigned*)(F.lds + LDSCTL_OFF))[u] = 0u;
    __syncthreads();
    unsigned char* ws = P.ws;
    XcdBarrier bar = xcd_barrier_post((unsigned*)(ws + WS_CTL) + CW_BAR, MISC + 8);

    p0_prologue(P, F);
    xcd_barrier(bar);

    { pg8::Gemm g{(const pg8::bf16_t*)(ws + WS_XN), (const pg8::bf16_t*)(ws + WS_WIN), M1, NCOL, DM}; pg8::StaticOrder S; S.init(M1, NCOL, F.G, (int)blockIdx.x);
      pg8::EpiG1 E{ws};
      pg8::gemm_phase<pg8::EpiG1, pg8::StaticOrder, true, true>(F.lds + RING_OFF, g, S, E); }
    xcd_barrier(bar);

    { const int gw = blockIdx.x * NWAVES + F.wave, NGW = F.G * NWAVES;
      for (int u = gw; u < NB * SBH * 256; u += NGW) sb_unit(ws, u >> 8, 1 + (u & 255), F.lane);
      for (int u = gw; u < NB * SWH * 256; u += NGW) sw_unit(ws, P.sinks, u >> 8, 1 + (u & 255), F.lane); }
    xcd_barrier(bar);

    { pg8::Gemm g{(const pg8::bf16_t*)(ws + WS_SZSB), (const pg8::bf16_t*)(ws + WS_WSB), MT, DM, 512}; pg8::StaticOrder S; S.init(MT, DM, F.G, (int)blockIdx.x);
      pg8::EpiGate<0> E{(const pg8::bf16_t*)(ws + WS_GSB), nullptr, (pg8::bf16_t*)(ws + WS_T)};
      pg8::gemm_phase<pg8::EpiGate<0>, pg8::StaticOrder, true, true>(F.lds + RING_OFF, g, S, E); }
    VM_WAIT(); __syncthreads();
    { pg8::Gemm g{(const pg8::bf16_t*)(ws + WS_SZSW), (const pg8::bf16_t*)(ws + WS_WSW), MT, DM, DM}; pg8::StaticOrder S; S.init(MT, DM, F.G, (int)blockIdx.x);
      pg8::EpiGate<1> E{(const pg8::bf16_t*)(ws + WS_GSW), (const pg8::bf16_t*)(ws + WS_T), (pg8::bf16_t*)(ws + WS_MERGED)};
      pg8::gemm_phase<pg8::EpiGate<1>, pg8::StaticOrder, true, true>(F.lds + RING_OFF, g, S, E); }
    xcd_barrier(bar);

    { pg8::Gemm g{(const pg8::bf16_t*)(ws + WS_MERGED), (const pg8::bf16_t*)(ws + WS_WOUT), MT, DM, DM}; pg8::StaticOrder S; S.init(MT, DM, F.G, (int)blockIdx.x);
      pg8::EpiOut E{P.x, P.out, (float*)(ws + WS_ROWSS)};
      pg8::gemm_phase<pg8::EpiOut, pg8::StaticOrder, true, true>(F.lds + RING_OFF, g, S, E); }
    xcd_barrier(bar);

    { const int gw = F.vcu * NWAVES + F.wave, NGW = F.G * NWAVES; const float* rowss = (const float*)(ws + WS_ROWSS);
      for (int m = gw; m < MT; m += NGW) {
          const float rstd = 1.0f / sqrtf(__hip_atomic_load(rowss + m, __ATOMIC_RELAXED, __HIP_MEMORY_SCOPE_AGENT) * (1.f / DM) + RMS_EPS);
          f32x4* r = (f32x4*)(P.out + (size_t)m * DM) + F.lane; const f32x4* gn = (const f32x4*)P.fgain + F.lane;
#pragma unroll
          for (int j = 0; j < 4; ++j) r[64 * j] = r[64 * j] * rstd * gn[64 * j];
      } }
}

extern "C" void kernel_launch(void* const* d_in, const int* in_sizes, int n_in, void* d_out, int out_size, void* d_ws, size_t ws_size, hipStream_t stream) {
    static int grid = 0;
    if (grid == 0) {
        if (n_in != 9 || out_size != MT * DM || ws_size < WS_END) { fprintf(stderr, "kernel_launch: unexpected sizes n_in %d out %d ws %zu; nothing launched\n", n_in, out_size, ws_size); grid = -1; return; }
        int dev = 0, cus = 0, per_cu = 0;
        if (hipGetDevice(&dev) != hipSuccess || hipDeviceGetAttribute(&cus, hipDeviceAttributeMultiprocessorCount, dev) != hipSuccess) { grid = -1; return; }
        if (hipFuncSetAttribute((const void*)mega_fwd, hipFuncAttributeMaxDynamicSharedMemorySize, LDS_BYTES) != hipSuccess) { fprintf(stderr, "kernel_launch: hipFuncSetAttribute failed\n"); grid = -1; return; }
        if (hipOccupancyMaxActiveBlocksPerMultiprocessor(&per_cu, (const void*)mega_fwd, NWAVES * 64, LDS_BYTES) != hipSuccess || per_cu < 1) fprintf(stderr, "kernel_launch: occupancy query says %d\n", per_cu);
        (void)hipGetLastError();
        grid = cus;
    }
    if (grid < 0) return;
    if (hipMemsetAsync((char*)d_ws + WS_CTL, 0, CTL_ZERO_BYTES, stream) != hipSuccess) return;
    Ptrs P{};
    P.x = (const float*)d_in[0]; P.meta = (const float*)d_in[1]; P.gain = (const float*)d_in[2]; P.w_in = (const float*)d_in[3]; P.w_sb = (const float*)d_in[4];
    P.w_sw = (const float*)d_in[5]; P.w_out = (const float*)d_in[6]; P.sinks = (const float*)d_in[7]; P.fgain = (const float*)d_in[8];
    P.out = (float*)d_out; P.ws = (unsigned char*)d_ws;
    for (int i = 0; i < 32; ++i) P.inv[i] = powf(10000.0f, -(float)i / 32.0f);
    hipLaunchKernelGGL(mega_fwd, dim3(grid), dim3(NWAVES * 64), LDS_BYTES, stream, P);
}
```
